# Optimizing an MI355X kernel written in HIP

```python
import jax, jax.numpy as jnp
from jax import lax
import numpy as np

D_MODEL = 1024
BATCH = 2
SEQ = 16384
DEPTH = 4
DEC_BATCH = 2
DEC_SEQ = 8192
PAST_LEN = 128

D_MIX = D_MODEL
HEAD_DIM = 64
N_HEADS = (D_MIX // 2) // HEAD_DIM
N_KV_HEADS = 2
GROUP = N_HEADS // N_KV_HEADS
ATTN_W = N_HEADS * HEAD_DIM
KV_W = N_KV_HEADS * HEAD_DIM
SG_W = D_MIX - ATTN_W
SG_GROUPS = 8
SG_GROUP_DIM = SG_W // SG_GROUPS
CHUNK = 128
Q_BLOCK = 128
GRID_W = 64
AXIS_DIM = HEAD_DIM // 2
ROPE_THETA = 10000.0
D_FF = 4 * D_MODEL
D_IN = ATTN_W + 2 * KV_W + 2 * SG_W
EPS = 1e-6

kernel_name = "hymba_gmlp_axial_gqa_encoder"


def rms_norm(x, g):
    xf = x.astype(jnp.float32)
    y = xf * lax.rsqrt(jnp.mean(xf * xf, axis=-1, keepdims=True) + EPS)
    return (y * g.astype(jnp.float32)).astype(x.dtype)


def layer_norm(x, g, b):
    xf = x.astype(jnp.float32)
    mu = jnp.mean(xf, axis=-1, keepdims=True)
    xc = xf - mu
    y = xc * lax.rsqrt(jnp.mean(xc * xc, axis=-1, keepdims=True) + EPS)
    return (y * g.astype(jnp.float32) + b.astype(jnp.float32)).astype(x.dtype)


def axial_rope_tables(seq_len):
    rows = seq_len // GRID_W
    r = jnp.broadcast_to(jnp.arange(rows)[:, None], (rows, GRID_W)).reshape(-1).astype(jnp.float32)
    c = jnp.broadcast_to(jnp.arange(GRID_W)[None, :], (rows, GRID_W)).reshape(-1).astype(jnp.float32)
    inv = ROPE_THETA ** (-jnp.arange(0, AXIS_DIM, 2, dtype=jnp.float32) / AXIS_DIM)
    ang_r = r[:, None] * inv
    ang_c = c[:, None] * inv
    ang = jnp.concatenate([ang_r, ang_r, ang_c, ang_c], axis=-1)
    return jnp.cos(ang)[None, :, None, :], jnp.sin(ang)[None, :, None, :]


def apply_axial_rope(x, cos, sin):
    xf = x.astype(jnp.float32)
    x4 = xf.reshape(xf.shape[:-1] + (2, 2, AXIS_DIM // 2))
    rot = jnp.stack([-x4[..., 1, :], x4[..., 0, :]], axis=-2).reshape(xf.shape)
    return (xf * cos + rot * sin).astype(x.dtype)


def gqa_axial(q, k, v, q_g, k_g):
    B, S, _ = q.shape
    q = q.reshape(B, S, N_HEADS, HEAD_DIM)
    k = k.reshape(B, S, N_KV_HEADS, HEAD_DIM)
    v = v.reshape(B, S, N_KV_HEADS, HEAD_DIM)
    cos, sin = axial_rope_tables(S)
    q = apply_axial_rope(rms_norm(q, q_g), cos, sin) * (HEAD_DIM ** -0.5)
    k = apply_axial_rope(rms_norm(k, k_g), cos, sin)
    nb = S // Q_BLOCK
    qb = q.reshape(B, nb, Q_BLOCK, N_KV_HEADS, GROUP, HEAD_DIM).transpose(1, 0, 2, 3, 4, 5)

    def one_block(qi):
        s = jnp.einsum('bqkgd,bskd->bkgqs', qi, k).astype(jnp.float32)
        p = jax.nn.softmax(s, axis=-1).astype(v.dtype)
        return jnp.einsum('bkgqs,bskd->bqkgd', p, v)

    o = lax.map(one_block, qb)
    return o.transpose(1, 0, 2, 3, 4, 5).reshape(B, S, ATTN_W)


def chunked_spatial_gating(z, ln_g, ln_b, w_s, b_s):
    B, S, _ = z.shape
    z = jax.nn.gelu(z)
    u, vv = z[..., :SG_W], z[..., SG_W:]
    vv = layer_norm(vv, ln_g, ln_b)
    vc = vv.reshape(B, S // CHUNK, CHUNK, SG_GROUPS, SG_GROUP_DIM)
    mixed = jnp.einsum('gij,bnjgc->bnigc', w_s, vc) + b_s.T[None, None, :, :, None]
    return u * mixed.reshape(B, S, SG_W)


def trunk(x, w_in, w_out, q_norm_g, k_norm_g, sg_norm_g, sg_norm_b, sg_w, sg_b,
          attn_out_g, sg_out_g, pre_mix_g, post_mix_g, pre_ffn_g, post_ffn_g, w_ff1, w_ff2):
    for l in range(DEPTH):
        h = rms_norm(x, pre_mix_g[l])
        z = h @ w_in[l]
        q = z[..., :ATTN_W]
        k = z[..., ATTN_W:ATTN_W + KV_W]
        v = z[..., ATTN_W + KV_W:ATTN_W + 2 * KV_W]
        zs = z[..., ATTN_W + 2 * KV_W:]
        a = gqa_axial(q, k, v, q_norm_g[l], k_norm_g[l])
        g = chunked_spatial_gating(zs, sg_norm_g[l], sg_norm_b[l], sg_w[l], sg_b[l])
        m = jnp.concatenate([rms_norm(a, attn_out_g[l]), rms_norm(g, sg_out_g[l])], axis=-1) @ w_out[l]
        x = x + rms_norm(m, post_mix_g[l])
        h = rms_norm(x, pre_ffn_g[l])
        f = jnp.square(jax.nn.relu(h @ w_ff1[l])) @ w_ff2[l]
        x = x + rms_norm(f, post_ffn_g[l])
    return x


def setup_inputs(seed: int = 0) -> dict:
    key = jax.random.key(seed)
    ks = jax.random.split(key, 20)
    f32 = jnp.float32

    def nrm(k, shape, scale):
        return jax.random.normal(k, shape, f32) * scale

    def gain(k, shape):
        return 1.0 + 0.02 * jax.random.normal(k, shape, f32)

    return {
        "x_prompt": jax.random.normal(ks[0], (BATCH, SEQ, D_MODEL), f32),
        "x_sample": jax.random.normal(ks[1], (DEC_BATCH, DEC_SEQ, D_MODEL), f32),
        "w_in": nrm(ks[2], (DEPTH, D_MODEL, D_IN), D_MODEL ** -0.5),
        "w_out": nrm(ks[3], (DEPTH, D_MIX, D_MODEL), D_MIX ** -0.5),
        "q_norm_g": gain(ks[4], (DEPTH, HEAD_DIM)),
        "k_norm_g": gain(ks[5], (DEPTH, HEAD_DIM)),
        "sg_norm_g": gain(ks[6], (DEPTH, SG_W)),
        "sg_norm_b": nrm(ks[7], (DEPTH, SG_W), 0.02),
        "sg_w": nrm(ks[8], (DEPTH, SG_GROUPS, CHUNK, CHUNK), CHUNK ** -0.5),
        "sg_b": gain(ks[9], (DEPTH, SG_GROUPS, CHUNK)),
        "attn_out_g": gain(ks[10], (DEPTH, ATTN_W)),
        "sg_out_g": gain(ks[11], (DEPTH, SG_W)),
        "pre_mix_g": gain(ks[12], (DEPTH, D_MODEL)),
        "post_mix_g": gain(ks[13], (DEPTH, D_MODEL)),
        "pre_ffn_g": gain(ks[14], (DEPTH, D_MODEL)),
        "post_ffn_g": gain(ks[15], (DEPTH, D_MODEL)),
        "w_ff1": nrm(ks[16], (DEPTH, D_MODEL, D_FF), D_MODEL ** -0.5),
        "w_ff2": nrm(ks[17], (DEPTH, D_FF, D_MODEL), D_FF ** -0.5),
    }


def reference(x_prompt, x_sample, w_in, w_out, q_norm_g, k_norm_g, sg_norm_g, sg_norm_b,
              sg_w, sg_b, attn_out_g, sg_out_g, pre_mix_g, post_mix_g, pre_ffn_g,
              post_ffn_g, w_ff1, w_ff2):
    y_prompt = trunk(x_prompt, w_in, w_out, q_norm_g, k_norm_g, sg_norm_g, sg_norm_b, sg_w, sg_b,
                     attn_out_g, sg_out_g, pre_mix_g, post_mix_g, pre_ffn_g, post_ffn_g, w_ff1, w_ff2)
    y_sample = trunk(x_sample, w_in, w_out, q_norm_g, k_norm_g, sg_norm_g, sg_norm_b, sg_w, sg_b,
                     attn_out_g, sg_out_g, pre_mix_g, post_mix_g, pre_ffn_g, post_ffn_g, w_ff1, w_ff2)
    return (y_prompt, y_sample)
```

```cpp
#include <hip/hip_runtime.h>
#include <hip/hip_cooperative_groups.h>
#include <cstdio>
#include <cstdint>
namespace cg = cooperative_groups;
namespace pg8 {
#define PG8_LAS __attribute__((address_space(3)))
typedef unsigned short bf16_t;
typedef short bf16x8 __attribute__((ext_vector_type(8)));
typedef float f32x4 __attribute__((ext_vector_type(4)));
typedef unsigned u32x4 __attribute__((ext_vector_type(4)));
constexpr int BM = 256, BK = 64, HALF = 128, HTB = HALF * BK * 2  , STAGE_BYTES = 8 * HTB, NXCD = 8, WGM = 8;

__host__ __device__ __forceinline__ int lds_byte(int r, int c) { const int st = (r >> 4) * 2 + (c >> 5), rr = r & 15, cc = c & 31, ob = rr * 64 + cc * 2; return st * 1024 + (ob ^ (((ob >> 9) & 1) << 5)); }
__host__ __device__ __forceinline__ void stage_rc(int b, int& R, int& C) { const int st = b / 1024, sb = b % 1024, swz = sb ^ (((sb >> 9) & 1) << 5); R = (st >> 1) * 16 + swz / 64; C = (st & 1) * 32 + (swz % 64) / 2; }
__host__ __device__ __forceinline__ int perm32(int rho) { const int n = rho >> 4, i = rho & 15; return 8 * (i >> 2) + 4 * n + (i & 3); }

struct Unit { int pm, pn; };
struct Gemm { const bf16_t* A; const bf16_t* Bt; int M, N, K; };

struct StaticOrder {
    int nM, nN, nwg, G, c;
    __host__ __device__ void init(int M, int N, int G_, int c_) { nM = M / BM; nN = N / BM; nwg = nM * nN; G = G_; c = c_; }
    __host__ __device__ bool next(int i, Unit& u) const {
        const long L = (long)i * G + c; if (L >= nwg) return false;
        int wgid = (int)L; { const int q = nwg / NXCD, r = nwg % NXCD, xcd = wgid % NXCD, off = wgid / NXCD; wgid = (xcd < r ? xcd * (q + 1) : r * (q + 1) + (xcd - r) * q) + off; }
        const int nig = WGM * nN, gid = wgid / nig, fm = gid * WGM, gsz = (nM - fm) < WGM ? (nM - fm) : WGM;
        u.pm = fm + ((wgid % nig) % gsz); u.pn = (wgid % nig) / gsz; return true;
    }
    __device__ __forceinline__ void a_ready(const Unit&) const {}
    __device__ __forceinline__ void done(const Unit&) const {}
};

__device__ __forceinline__ unsigned cvt_pk_bf16(float lo, float hi) { unsigned r; asm volatile("v_cvt_pk_bf16_f32 %0, %1, %2" : "=v"(r) : "v"(lo), "v"(hi)); return r; }
typedef float f32x2 __attribute__((ext_vector_type(2)));
template <int MODE> struct EpiOut {
    static constexpr bool PERM = true, AFTER_DRAIN = false;
    bf16_t* O; int ldc; bf16_t* O2; bf16_t* O3; bf16_t* O4;
    __device__ __forceinline__ void operator()(const f32x4 (&acc)[2][2][4][2], const Unit& u, int wr, int wc, int fr, int fq) const {
        const int row0 = u.pm * BM + wr * 64 + fr;
        bf16_t* base = O; int ld = ldc; int colt = u.pn * BM;
        if (MODE == 2) { const int pn = u.pn;
            if (pn < 2) { base = O; ld = 512; colt = pn * 256; }
            else if (pn == 2) { base = O2; ld = 256; colt = 0; }
            else if (pn < 5) { base = O3; ld = 512; colt = (pn - 3) * 256; }
            else { base = O4; ld = 512; colt = (pn - 5) * 256; } }
        const int col0 = colt + wc * 32 + 8 * fq;
#pragma unroll
        for (int ai = 0; ai < 2; ++ai)
#pragma unroll
            for (int m = 0; m < 4; ++m) { bf16_t* rowp = base + (size_t)(row0 + ai * HALF + m * 16) * ld + col0;
#pragma unroll
                for (int bj = 0; bj < 2; ++bj) { f32x4 v0 = acc[ai][bj][m][0], v1 = acc[ai][bj][m][1];
                    if (MODE == 1) {
#pragma unroll
                        for (int e = 0; e < 4; ++e) { float a = v0[e] > 0.f ? v0[e] : 0.f; v0[e] = a * a; float b = v1[e] > 0.f ? v1[e] : 0.f; v1[e] = b * b; } }
                    u32x4 w; w.x = cvt_pk_bf16(v0[0], v0[1]); w.y = cvt_pk_bf16(v0[2], v0[3]); w.z = cvt_pk_bf16(v1[0], v1[1]); w.w = cvt_pk_bf16(v1[2], v1[3]);
                    *(u32x4*)(rowp + bj * HALF) = w; } }
    }
};
template <class Epi, class Sched, bool ALIGN_EPI = false, bool SP2 = false>
__device__ __forceinline__ void gemm_phase(PG8_LAS unsigned char* lds, const Gemm g, const Sched& S, const Epi& E) {
    int tid_l = threadIdx.x; asm volatile("" : "+v"(tid_l));
    const int tid = tid_l, wid = __builtin_amdgcn_readfirstlane(tid >> 6), lane = tid & 63, wr = wid >> 2, wc = wid & 3, fr = lane & 15, fq = lane >> 4;
    const int K = g.K, nt = K / BK;
    unsigned voffA[2], voffB[2];
#pragma unroll
    for (int i = 0; i < 2; ++i) { int R, C; stage_rc(tid * 16 + i * 8192, R, C); const int Rb = Epi::PERM ? ((R & ~31) + perm32(R & 31)) : R;
        voffA[i] = (unsigned)(R * K + C) * 2u; voffB[i] = (unsigned)(Rb * K + C) * 2u; }
    const size_t kstep = (size_t)(BK * 2);
    const size_t hstep = (size_t)HALF * K * 2;
    const size_t tstep = 2 * hstep;
    const unsigned ldsw = (unsigned)wid * 1024u;
    const int aoff = lds_byte(wr * 64 + fr, fq * 8), boff = lds_byte(wc * 32 + fr, fq * 8);
#define PG8_SA(b, h) (((b) * 2 + (h)) * HTB)
#define PG8_SB(b, h) ((4 + (b) * 2 + (h)) * HTB)
#define PG8_STAGE(bufoff, gbase, voff) do { _Pragma("unroll") for (int _i = 0; _i < 2; ++_i) \
        __builtin_amdgcn_global_load_lds((const unsigned*)((const char*)(gbase) + (voff)[_i]), (PG8_LAS unsigned*)(lds + (bufoff) + ldsw + _i * 8192), 16, 0, 0); } while (0)
#define PG8_LDA(dst, b, h) do { _Pragma("unroll") for (int m = 0; m < 4; ++m) _Pragma("unroll") for (int k = 0; k < 2; ++k) dst[m][k] = *(const PG8_LAS bf16x8*)(lds + PG8_SA(b, h) + aoff + m * 2048 + k * 1024); } while (0)
#define PG8_LDB(dst, b, h) do { _Pragma("unroll") for (int n = 0; n < 2; ++n) _Pragma("unroll") for (int k = 0; k < 2; ++k) dst[n][k] = *(const PG8_LAS bf16x8*)(lds + PG8_SB(b, h) + boff + n * 2048 + k * 1024); } while (0)
#define PG8_MMA(ai, bj, At, Bt) do { __builtin_amdgcn_s_setprio(1); _Pragma("unroll") for (int m = 0; m < 4; ++m) _Pragma("unroll") for (int n = 0; n < 2; ++n) _Pragma("unroll") for (int k = 0; k < 2; ++k) \
        acc[ai][bj][m][n] = __builtin_amdgcn_mfma_f32_16x16x32_bf16(Bt[n][k], At[m][k], acc[ai][bj][m][n], 0, 0, 0); __builtin_amdgcn_s_setprio(0); } while (0)
#define PG8_WAIT_V(n) asm volatile("s_waitcnt vmcnt(" #n ")" ::: "memory")
#define PG8_WAIT_L(n) asm volatile("s_waitcnt lgkmcnt(" #n ")" ::: "memory")
#define PG8_BAR __builtin_amdgcn_s_barrier()
#define PG8_SCHED __builtin_amdgcn_sched_barrier(0)
    Unit cur, nxt; int ui = 0;
    if (!S.next(0, cur)) return;
    f32x4 acc[2][2][4][2];
#pragma unroll
    for (int a = 0; a < 2; ++a)
#pragma unroll
        for (int b = 0; b < 2; ++b)
#pragma unroll
            for (int m = 0; m < 4; ++m)
#pragma unroll
                for (int n = 0; n < 2; ++n) acc[a][b][m][n] = (f32x4){0.f, 0.f, 0.f, 0.f};
    bf16x8 At[4][2], B0[2][2], B1[2][2];
    const char* cA = (const char*)g.A + (size_t)cur.pm * tstep; const char* cB = (const char*)g.Bt + (size_t)cur.pn * tstep;
    S.a_ready(cur);
    if constexpr (SP2) {
        PG8_STAGE(PG8_SB(0, 0), cB, voffB); PG8_STAGE(PG8_SB(0, 1), cB + hstep, voffB); PG8_STAGE(PG8_SA(0, 0), cA, voffA); PG8_STAGE(PG8_SA(0, 1), cA + hstep, voffA);
        if (wr == 1) PG8_BAR;
        PG8_WAIT_V(2); PG8_BAR;
        PG8_STAGE(PG8_SB(1, 0), cB + kstep, voffB); PG8_STAGE(PG8_SA(1, 0), cA + kstep, voffA); PG8_STAGE(PG8_SB(1, 1), cB + hstep + kstep, voffB);
        PG8_WAIT_V(6); PG8_BAR;
    } else {
        PG8_STAGE(PG8_SB(0, 0), cB, voffB); PG8_STAGE(PG8_SA(0, 0), cA, voffA); PG8_STAGE(PG8_SB(0, 1), cB + hstep, voffB); PG8_STAGE(PG8_SA(0, 1), cA + hstep, voffA);
        if (wr == 1) PG8_BAR;
        PG8_WAIT_V(4); PG8_BAR;
        PG8_STAGE(PG8_SB(1, 0), cB + kstep, voffB); PG8_STAGE(PG8_SA(1, 0), cA + kstep, voffA); PG8_STAGE(PG8_SB(1, 1), cB + hstep + kstep, voffB);
        PG8_WAIT_V(6); PG8_BAR;
    }
    for (;;) {
        const bool has_next = S.next(ui + 1, nxt);
        const char* nA = has_next ? (const char*)g.A + (size_t)nxt.pm * tstep : cA; const char* nB = has_next ? (const char*)g.Bt + (size_t)nxt.pn * tstep : cB;
        for (int t = 0; t < nt; t += 2) {
            const bool last = (t == nt - 2);
            const char* a1 = cA + (size_t)(t + 1) * kstep;
            const char* a2 = last ? nA : cA + (size_t)(t + 2) * kstep; const char* b2 = last ? nB : cB + (size_t)(t + 2) * kstep;
            const char* a3 = a2 + kstep; const char* b3 = b2 + kstep;
            if (last && has_next) S.a_ready(nxt);
            if constexpr (SP2) {
            PG8_LDB(B0, 0, 0); PG8_LDB(B1, 0, 1); PG8_SCHED; PG8_LDA(At, 0, 0); PG8_STAGE(PG8_SA(1, 1), a1 + hstep, voffA);
            PG8_WAIT_V(8); PG8_WAIT_L(0); PG8_BAR; PG8_MMA(0, 0, At, B0); PG8_MMA(0, 1, At, B1); PG8_BAR; PG8_SCHED;
            PG8_LDA(At, 0, 1); PG8_STAGE(PG8_SB(0, 0), b2, voffB); PG8_STAGE(PG8_SB(0, 1), b2 + hstep, voffB); PG8_STAGE(PG8_SA(0, 0), a2, voffA);
            PG8_WAIT_V(8); PG8_WAIT_L(0); PG8_BAR; PG8_MMA(1, 0, At, B0); PG8_MMA(1, 1, At, B1); PG8_BAR; PG8_SCHED;
            PG8_LDB(B0, 1, 0); PG8_LDB(B1, 1, 1); PG8_SCHED; PG8_LDA(At, 1, 0); PG8_STAGE(PG8_SA(0, 1), a2 + hstep, voffA);
            PG8_WAIT_V(8); PG8_WAIT_L(0); PG8_BAR; PG8_MMA(0, 0, At, B0); PG8_MMA(0, 1, At, B1); PG8_BAR; PG8_SCHED;
            PG8_LDA(At, 1, 1); PG8_STAGE(PG8_SB(1, 0), b3, voffB); PG8_STAGE(PG8_SB(1, 1), b3 + hstep, voffB); PG8_STAGE(PG8_SA(1, 0), a3, voffA);
            PG8_WAIT_V(8); PG8_WAIT_L(0); PG8_BAR; PG8_MMA(1, 0, At, B0); PG8_MMA(1, 1, At, B1); PG8_BAR; PG8_SCHED;
            } else {
            PG8_LDB(B0, 0, 0); PG8_SCHED; PG8_LDA(At, 0, 0); PG8_STAGE(PG8_SA(1, 1), a1 + hstep, voffA);
            PG8_WAIT_L(8); PG8_BAR; PG8_WAIT_L(0); PG8_MMA(0, 0, At, B0); PG8_BAR; PG8_SCHED;
            PG8_LDB(B1, 0, 1); PG8_STAGE(PG8_SB(0, 0), b2, voffB);
            PG8_BAR; PG8_WAIT_L(0); PG8_MMA(0, 1, At, B1); PG8_BAR;
            PG8_LDA(At, 0, 1); PG8_STAGE(PG8_SA(0, 0), a2, voffA);
            PG8_BAR; PG8_WAIT_L(0); PG8_MMA(1, 0, At, B0); PG8_BAR; PG8_SCHED;
            PG8_STAGE(PG8_SB(0, 1), b2 + hstep, voffB);
            PG8_WAIT_V(6); PG8_BAR; PG8_MMA(1, 1, At, B1); PG8_BAR;
            PG8_LDB(B0, 1, 0); PG8_SCHED; PG8_LDA(At, 1, 0); PG8_STAGE(PG8_SA(0, 1), a2 + hstep, voffA);
            PG8_WAIT_L(8); PG8_BAR; PG8_WAIT_L(0); PG8_MMA(0, 0, At, B0); PG8_BAR; PG8_SCHED;
            PG8_LDB(B1, 1, 1); PG8_STAGE(PG8_SB(1, 0), b3, voffB);
            PG8_BAR; PG8_WAIT_L(0); PG8_MMA(0, 1, At, B1); PG8_BAR;
            PG8_LDA(At, 1, 1); PG8_STAGE(PG8_SA(1, 0), a3, voffA);
            PG8_BAR; PG8_WAIT_L(0); PG8_MMA(1, 0, At, B0); PG8_BAR; PG8_SCHED;
            PG8_STAGE(PG8_SB(1, 1), b3 + hstep, voffB);
            PG8_WAIT_V(6); PG8_BAR; PG8_MMA(1, 1, At, B1); PG8_BAR;
            }
        }
        if constexpr (ALIGN_EPI) { if (wr == 0) PG8_BAR; }
        if constexpr (!Epi::AFTER_DRAIN) { E(acc, cur, wr, wc, fr, fq); S.done(cur); }
        if (!has_next) break;
#pragma unroll
        for (int a = 0; a < 2; ++a)
#pragma unroll
            for (int b = 0; b < 2; ++b)
#pragma unroll
                for (int m = 0; m < 4; ++m)
#pragma unroll
                    for (int n = 0; n < 2; ++n) acc[a][b][m][n] = (f32x4){0.f, 0.f, 0.f, 0.f};
        cur = nxt; cA = nA; cB = nB; ++ui;
        if constexpr (ALIGN_EPI) { if (wr == 1) PG8_BAR; }
    }
    PG8_WAIT_V(0);
    if constexpr (!ALIGN_EPI) { if (wr == 0) PG8_BAR; }
    PG8_BAR;
    if constexpr (Epi::AFTER_DRAIN) { E.fused(acc, cur, wr, wc, fr, fq, lds, wid, lane); S.done(cur); }
#undef PG8_SA
#undef PG8_SB
#undef PG8_STAGE
#undef PG8_LDA
#undef PG8_LDB
#undef PG8_MMA
#undef PG8_WAIT_V
#undef PG8_WAIT_L
#undef PG8_BAR
#undef PG8_SCHED
}
}
#include <hip/hip_bf16.h>
#include <cmath>
namespace attn_body {
using bf16=__hip_bfloat16;
using bf16x8=__attribute__((ext_vector_type(8)))short;
using s16x4=__attribute__((ext_vector_type(4)))short;
using f32x16=__attribute__((ext_vector_type(16)))float;
using u32x4=__attribute__((ext_vector_type(4)))unsigned;
constexpr int D=64,QP=512,KP=256,OP=1024;
constexpr int NW=8,QBLK=32,QB=QBLK*NW,KVBLK=64;
constexpr int ATTN_UNIT_ROWS=QB;
__device__ __forceinline__ int crow(int r,int hi){return (r&3)+8*(r>>2)+4*hi;}
#define SBAR() __builtin_amdgcn_sched_barrier(0)
constexpr int NSLOT=3, SLOTB=8192;
constexpr int LDS_K=0, LDS_V=NSLOT*SLOTB, LDS_WS=2*NSLOT*SLOTB, LDS_OST=LDS_WS+NW*64*4, LDS_BYTES=LDS_OST+NW*4096;
constexpr float C2=0.125f*1.4426950408889634f;
__device__ __forceinline__ void glds16(const void*gsrc,unsigned lds_dst){unsigned keep;
  asm volatile("s_mov_b32 %0, m0\n\ts_mov_b32 m0, %2\n\ts_nop 0\n\tglobal_load_lds_dwordx4 %1, off\n\ts_mov_b32 m0, %0":"=&s"(keep):"v"(gsrc),"s"(lds_dst):"memory");}
__device__ __forceinline__ float max3f(float a,float b,float c){float r;asm("v_max3_f32 %0, %1, %2, %3":"=v"(r):"v"(a),"v"(b),"v"(c));return r;}
__device__ __forceinline__ float max2f(float a,float b){float r;asm("v_max_f32_e32 %0, %1, %2":"=v"(r):"v"(a),"v"(b));return r;}
__device__ __forceinline__ float fadd_s(float a,float b){float r;asm("v_add_f32_e32 %0, %1, %2":"=v"(r):"v"(a),"v"(b));return r;}
__device__ __forceinline__ float fsub_s(float a,float b){float r;asm("v_sub_f32_e32 %0, %1, %2":"=v"(r):"v"(a),"v"(b));return r;}
typedef float f32x2_t __attribute__((ext_vector_type(2))); typedef __bf16 bf16x2_t __attribute__((ext_vector_type(2)));
__device__ __forceinline__ unsigned cvtpk_s(float lo,float hi){f32x2_t v={lo,hi};bf16x2_t b=__builtin_convertvector(v,bf16x2_t);return __builtin_bit_cast(unsigned,b);}
#define WAIT_BAR(N) asm volatile("s_waitcnt vmcnt(" #N ") lgkmcnt(0)\n\ts_barrier":::"memory")

__device__ __forceinline__ void qkt(f32x16&p0,f32x16&p1,const char*Kslot,const bf16x8*qr,const f32x16&negm,int r32,int hi){
  const char*kb=Kslot+hi*1024+r32*16;
  #pragma unroll
  for(int d0=0;d0<4;++d0){
    const bf16x8 b0=*reinterpret_cast<const bf16x8*>(kb+d0*2048);
    const bf16x8 b1=*reinterpret_cast<const bf16x8*>(kb+d0*2048+512);
    if(d0==0){p0=__builtin_amdgcn_mfma_f32_32x32x16_bf16(b0,qr[0],negm,0,0,0);p1=__builtin_amdgcn_mfma_f32_32x32x16_bf16(b1,qr[0],negm,0,0,0);}
    else{p0=__builtin_amdgcn_mfma_f32_32x32x16_bf16(b0,qr[d0],p0,0,0,0);p1=__builtin_amdgcn_mfma_f32_32x32x16_bf16(b1,qr[d0],p1,0,0,0);}}
}
typedef __attribute__((address_space(3))) const char* lds_cptr;
typedef short v4i16_t __attribute__((ext_vector_type(4)));
__device__ __forceinline__ void kload8(bf16x8*kf,lds_cptr kp){
  kf[0]=*(const __attribute__((address_space(3))) bf16x8*)(kp);      kf[1]=*(const __attribute__((address_space(3))) bf16x8*)(kp+512);
  kf[2]=*(const __attribute__((address_space(3))) bf16x8*)(kp+2048); kf[3]=*(const __attribute__((address_space(3))) bf16x8*)(kp+2560);
  kf[4]=*(const __attribute__((address_space(3))) bf16x8*)(kp+4096); kf[5]=*(const __attribute__((address_space(3))) bf16x8*)(kp+4608);
  kf[6]=*(const __attribute__((address_space(3))) bf16x8*)(kp+6144); kf[7]=*(const __attribute__((address_space(3))) bf16x8*)(kp+6656);
}
__device__ __forceinline__ void kload2(bf16x8*kf,lds_cptr kp,int j){ kf[2*j]=*(const __attribute__((address_space(3))) bf16x8*)(kp+j*2048); kf[2*j+1]=*(const __attribute__((address_space(3))) bf16x8*)(kp+j*2048+512); }
__device__ __forceinline__ s16x4 vtr(lds_cptr p){ return __builtin_bit_cast(s16x4,__builtin_amdgcn_ds_read_tr16_b64_v4i16((__attribute__((address_space(3))) v4i16_t*)p)); }
__device__ __forceinline__ float rowmax(const f32x16&p0,const f32x16&p1){
  float a=max3f(p0[0],p0[1],p1[0]),b=max3f(p0[2],p0[3],p1[1]);a=max3f(a,p1[2],p1[3]);
  #pragma unroll
  for(int r=4;r<16;r+=4){a=max3f(a,p0[r],p0[r+1]);b=max3f(b,p0[r+2],p0[r+3]);a=max3f(a,p1[r],p1[r+1]);b=max3f(b,p1[r+2],p1[r+3]);}
  const float m=max2f(a,b);
  auto rr=__builtin_amdgcn_permlane32_swap(__float_as_uint(m),__float_as_uint(m),false,false);
  return max2f(__uint_as_float(rr[0]),__uint_as_float(rr[1]));
}
__device__ __forceinline__ void pv(f32x16*o,int vb,bf16x8 pa0,bf16x8 pa1,bf16x8 pa2,bf16x8 pa3){
  #pragma unroll
  for(int d0=0;d0<2;++d0){s16x4 lo[4],hi[4];
    #pragma unroll
    for(int ks=0;ks<4;++ks){
      asm volatile("ds_read_b64_tr_b16 %0,%1 offset:%c2":"=&v"(lo[ks]):"v"(vb),"i"(d0*4096+ks*1024):"memory");
      asm volatile("ds_read_b64_tr_b16 %0,%1 offset:%c2":"=&v"(hi[ks]):"v"(vb),"i"(d0*4096+ks*1024+512):"memory");}
    asm volatile("s_waitcnt lgkmcnt(0)":::"memory");SBAR();
    #define PK(k) (bf16x8){lo[k][0],lo[k][1],lo[k][2],lo[k][3],hi[k][0],hi[k][1],hi[k][2],hi[k][3]}
    o[d0]=__builtin_amdgcn_mfma_f32_32x32x16_bf16(pa0,PK(0),o[d0],0,0,0);
    o[d0]=__builtin_amdgcn_mfma_f32_32x32x16_bf16(pa1,PK(1),o[d0],0,0,0);
    o[d0]=__builtin_amdgcn_mfma_f32_32x32x16_bf16(pa2,PK(2),o[d0],0,0,0);
    o[d0]=__builtin_amdgcn_mfma_f32_32x32x16_bf16(pa3,PK(3),o[d0],0,0,0);
    #undef PK
  }
}

#ifndef ATTN_STORE16
#define ATTN_STORE16(p,v) (*(u32x4*)(p)=(v))
#endif
template<int THRL> __device__ __forceinline__ void attn_unit(long rowbase,int h,int kvh,int qb,int NT,const bf16*__restrict__ Q,const bf16*__restrict__ KV,bf16*__restrict__ O,char*shm){
  int tid_l=threadIdx.x; asm volatile("":"+v"(tid_l));
  const int tid=tid_l,lane=tid&63,r32=lane&31,hi=lane>>5; const int wid=__builtin_amdgcn_readfirstlane(tid>>6);
  const int q0=qb*QB;
  const bf16*Qw=Q+(rowbase+q0+wid*QBLK)*QP+h*D;
  const bf16*Kh=KV+rowbase*KP+kvh*D,*Vh=KV+rowbase*KP+128+kvh*D;
  const unsigned lds0=(unsigned)(uintptr_t)shm;
  float*wsf=(float*)(shm+LDS_WS)+wid*64;
  const bf16*ksrc=Kh+(long)lane*KP+wid*8;
  const bf16*vsrc=Vh+(long)(16*(wid&3)+(lane>>2))*KP+(wid>>2)*32+(lane&3)*8;
  const unsigned kdst=lds0+LDS_K+wid*1024, vdst=lds0+LDS_V+wid*1024;
  #define DMA_K(t,slot) glds16(ksrc+(long)(t)*KVBLK*KP,(unsigned)__builtin_amdgcn_readfirstlane(kdst+(slot)))
  #define DMA_V(t,slot) glds16(vsrc+(long)(t)*KVBLK*KP,(unsigned)__builtin_amdgcn_readfirstlane(vdst+(slot)))
  const int vb0=(int)(lds0+LDS_V)+((lane>>4)&1)*32+(lane&3)*8+(4*hi+((lane&15)>>2))*64;
  const char*Kbase=shm+LDS_K; bf16x8 kf[8];
  const lds_cptr shm3=(lds_cptr)shm; const lds_cptr kp0=shm3+LDS_K+hi*1024+r32*16; const lds_cptr vp0=shm3+LDS_V+((lane>>4)&1)*32+(lane&3)*8+(4*hi+((lane&15)>>2))*64;
  DMA_K(0,0);DMA_V(0,0);DMA_K(1,SLOTB);
  bf16x8 qr[4];
  #pragma unroll
  for(int d0=0;d0<4;++d0)qr[d0]=*reinterpret_cast<const bf16x8*>(&Qw[(long)r32*QP+d0*16+hi*8]);
  float mhat=0.f,l_reg=0.f;f32x16 o[2];o[0]=f32x16{};o[1]=f32x16{};f32x16 negm=f32x16{};asm volatile("":"+v"(negm));
  #define CMASK(P0,P1,t) do{}while(0)
  bool resc=false;
  #define START(P0,P1) do{ const float rm=rowmax(P0,P1); resc=false; \
    { const float dl=rm; mhat=fadd_s(mhat,dl); \
      _Pragma("unroll") for(int r=0;r<16;++r){P0[r]=fsub_s(P0[r],dl);P1[r]=fsub_s(P1[r],dl);} \
      _Pragma("unroll") for(int r=0;r<16;++r)negm[r]=-mhat; asm volatile("":"+v"(negm)); } \
    _Pragma("unroll") for(int r=0;r<16;++r)P0[r]=__builtin_amdgcn_exp2f(P0[r]); }while(0)
  #define RESC() do{ if(resc){ asm volatile("s_waitcnt lgkmcnt(0)":::"memory"); \
      _Pragma("unroll") for(int d_=0;d_<2;++d_) _Pragma("unroll") for(int r=0;r<16;++r)o[d_][r]*=wsf[crow(r,hi)]; } }while(0)
  f32x16 pA0,pA1,pB0,pB1;
  int sl_prev=0,sl_cur=0,sl_next=SLOTB;
  #define ROT() do{sl_prev=sl_cur;sl_cur=sl_next;sl_next=(sl_next==(NSLOT-1)*SLOTB)?0:sl_next+SLOTB;}while(0)
  DMA_K(2,2*SLOTB);
  WAIT_BAR(3);
  qkt(pA0,pA1,Kbase,qr,negm,r32,hi);asm volatile("s_nop 15\n\ts_nop 7":"+v"(pA0),"+v"(pA1));CMASK(pA0,pA1,0);
  START(pA0,pA1);
  _Pragma("unroll") for(int r=0;r<16;++r)pA1[r]=__builtin_amdgcn_exp2f(pA1[r]);
  WAIT_BAR(0);
  DMA_K(3,0);DMA_V(1,SLOTB);
  ROT();
  kload8(kf,kp0+sl_cur);
  WAIT_BAR(2);
  s16x4 vlo[8],vhi[8]; u32x4 pw0,pw1,pw2,pw3;
  #define PKW(P,B) cvtpk_s(P[B],P[B+1])
  #define PAF(k) __builtin_bit_cast(bf16x8,pw##k)
  #define VFR(i) (bf16x8){vlo[i][0],vlo[i][1],vlo[i][2],vlo[i][3],vhi[i][0],vhi[i][1],vhi[i][2],vhi[i][3]}
  #define PIN(x) asm volatile("":"+v"(x))
  #define MX3(a,b,c) __builtin_fmaxf(__builtin_fmaxf((a),(b)),(c))
  #define GAPA(MF,A0,A1,A2,A3,W0,W1,PW) do{ MF; sacc+=A0; sacc+=A1; sacc+=A2; sacc+=A3; PIN(sacc); W0; W1; PIN(PW); SBAR(); }while(0)
  #define EX(v) __builtin_amdgcn_exp2f(v)
  #define GAPB(MF,X,B) do{ MF; X[B]=EX(X[B]); X[B+1]=EX(X[B+1]); X[B+2]=EX(X[B+2]); X[B+3]=EX(X[B+3]); PIN(X); SBAR(); }while(0)
  #define VRD(i) do{ vlo[i]=vtr(vp_+(((i)>>2)*4096+((i)&3)*1024)); vhi[i]=vtr(vp_+(((i)>>2)*4096+((i)&3)*1024+512)); }while(0)
  #define KRD(G,j) do{ if(G){ kload2(kf,kp0+sl_next,j); SBAR(); } }while(0)
  #define STEP(C0,C1,P0,P1,t,GK,GV,GL) do{ SBAR(); \
    const lds_cptr vp_=vp0+sl_prev; \
    VRD(0); SBAR(); float sacc=(P0[0]+P0[1]); \
    GAPA(C0=__builtin_amdgcn_mfma_f32_32x32x16_bf16(kf[0],qr[0],negm,0,0,0), P0[2],P0[3],P0[4],P0[5],     pw0[0]=PKW(P0,0), pw0[1]=PKW(P0,2), pw0); \
    VRD(4); SBAR(); GAPA(C1=__builtin_amdgcn_mfma_f32_32x32x16_bf16(kf[1],qr[0],negm,0,0,0), P0[6],P0[7],P0[8],P0[9],     pw0[2]=PKW(P0,4), pw0[3]=PKW(P0,6), pw0); \
    VRD(1); SBAR(); GAPA(C0=__builtin_amdgcn_mfma_f32_32x32x16_bf16(kf[2],qr[1],C0,0,0,0),   P0[10],P0[11],P0[12],P0[13], pw1[0]=PKW(P0,8), pw1[1]=PKW(P0,10), pw1); \
    VRD(5); SBAR(); GAPA(C1=__builtin_amdgcn_mfma_f32_32x32x16_bf16(kf[3],qr[1],C1,0,0,0),   P0[14],P0[15],P1[0],P1[1],   pw1[2]=PKW(P0,12),pw1[3]=PKW(P0,14), pw1); \
    VRD(2); SBAR(); GAPA(C0=__builtin_amdgcn_mfma_f32_32x32x16_bf16(kf[4],qr[2],C0,0,0,0),   P1[2],P1[3],P1[4],P1[5],     pw2[0]=PKW(P1,0), pw2[1]=PKW(P1,2), pw2); \
    VRD(6); SBAR(); GAPA(C1=__builtin_amdgcn_mfma_f32_32x32x16_bf16(kf[5],qr[2],C1,0,0,0),   P1[6],P1[7],P1[8],P1[9],     pw2[2]=PKW(P1,4), pw2[3]=PKW(P1,6), pw2); \
    VRD(3); SBAR(); GAPA(C0=__builtin_amdgcn_mfma_f32_32x32x16_bf16(kf[6],qr[3],C0,0,0,0),   P1[10],P1[11],P1[12],P1[13], pw3[0]=PKW(P1,8), pw3[1]=PKW(P1,10), pw3); \
    VRD(7); SBAR(); GAPA(C1=__builtin_amdgcn_mfma_f32_32x32x16_bf16(kf[7],qr[3],C1,0,0,0),   P1[14],P1[15],0.f,0.f,       pw3[2]=PKW(P1,12),pw3[3]=PKW(P1,14), pw3); \
    l_reg+=sacc; \
    if(GK){DMA_K((t)+3,sl_cur);} if(GV){DMA_V((t)+1,sl_next);} \
    CMASK(C0,C1,t); \
    { float a=MX3(C0[0],C0[1],C1[0]),b=MX3(C0[2],C0[3],C1[1]); a=MX3(a,C1[2],C1[3]); \
      _Pragma("unroll") for(int r=4;r<16;r+=4){a=MX3(a,C0[r],C0[r+1]);b=MX3(b,C0[r+2],C0[r+3]);a=MX3(a,C1[r],C1[r+1]);b=MX3(b,C1[r+2],C1[r+3]);} \
      float rm=__builtin_fmaxf(a,b); { auto rr=__builtin_amdgcn_permlane32_swap(__float_as_uint(rm),__float_as_uint(rm),false,false); rm=__builtin_fmaxf(__uint_as_float(rr[0]),__uint_as_float(rr[1])); } \
      resc=false; \
      if(__builtin_expect(__any(rm>(float)THRL),0)){ const float dl=__builtin_fmaxf(rm,0.f); mhat+=dl; \
        _Pragma("unroll") for(int r=0;r<16;++r){C0[r]-=dl;C1[r]-=dl;} \
        _Pragma("unroll") for(int r=0;r<16;++r)negm[r]=-mhat; asm volatile("":"+v"(negm)); \
        const float f=__builtin_amdgcn_exp2f(-dl); l_reg*=f; if(hi==0)wsf[r32]=f; resc=true; } } \
    SBAR(); \
    GAPB(o[0]=__builtin_amdgcn_mfma_f32_32x32x16_bf16(PAF(0),VFR(0),o[0],0,0,0), C0,0); \
    GAPB(o[1]=__builtin_amdgcn_mfma_f32_32x32x16_bf16(PAF(0),VFR(4),o[1],0,0,0), C0,4); \
    KRD(GL,0); GAPB(o[0]=__builtin_amdgcn_mfma_f32_32x32x16_bf16(PAF(1),VFR(1),o[0],0,0,0), C0,8); \
    KRD(GL,1); GAPB(o[1]=__builtin_amdgcn_mfma_f32_32x32x16_bf16(PAF(1),VFR(5),o[1],0,0,0), C0,12); \
    KRD(GL,2); GAPB(o[0]=__builtin_amdgcn_mfma_f32_32x32x16_bf16(PAF(2),VFR(2),o[0],0,0,0), C1,0); \
    KRD(GL,3); GAPB(o[1]=__builtin_amdgcn_mfma_f32_32x32x16_bf16(PAF(2),VFR(6),o[1],0,0,0), C1,4); \
    GAPB(o[0]=__builtin_amdgcn_mfma_f32_32x32x16_bf16(PAF(3),VFR(3),o[0],0,0,0), C1,8); \
    GAPB(o[1]=__builtin_amdgcn_mfma_f32_32x32x16_bf16(PAF(3),VFR(7),o[1],0,0,0), C1,12); \
    }while(0)
  int t=1;
  #undef CMASK
  #define CMASK(P0,P1,t) do{}while(0)
  for(;t+5<NT;t+=2){
    STEP(pB0,pB1,pA0,pA1,t,true,true,true);     WAIT_BAR(2); RESC(); ROT();
    STEP(pA0,pA1,pB0,pB1,t+1,true,true,true);   WAIT_BAR(2); RESC(); ROT();
  }
  #undef CMASK
  #define CMASK(P0,P1,t) do{}while(0)
  #define ENDW(tt) do{ if((tt)+3<NT){WAIT_BAR(2);} else if((tt)+2<NT){WAIT_BAR(1);} else {WAIT_BAR(0);} }while(0)
  for(;t+1<NT;t+=2){
    STEP(pB0,pB1,pA0,pA1,t,(t+3<NT),(t+1<NT),(t+1<NT));       ENDW(t);   RESC(); ROT();
    STEP(pA0,pA1,pB0,pB1,t+1,(t+4<NT),(t+2<NT),(t+2<NT));     ENDW(t+1); RESC(); ROT();
  }
  STEP(pB0,pB1,pA0,pA1,NT-1,false,false,false); RESC();
  { float sacc=pB0[0]+pB0[1]; _Pragma("unroll") for(int r=2;r<16;++r)sacc+=pB0[r]; _Pragma("unroll") for(int r=0;r<16;++r)sacc+=pB1[r]; l_reg+=sacc;
    pw0=(u32x4){PKW(pB0,0),PKW(pB0,2),PKW(pB0,4),PKW(pB0,6)};pw1=(u32x4){PKW(pB0,8),PKW(pB0,10),PKW(pB0,12),PKW(pB0,14)};pw2=(u32x4){PKW(pB1,0),PKW(pB1,2),PKW(pB1,4),PKW(pB1,6)};pw3=(u32x4){PKW(pB1,8),PKW(pB1,10),PKW(pB1,12),PKW(pB1,14)};
    SBAR(); pv(o,vb0+sl_cur,PAF(0),PAF(1),PAF(2),PAF(3)); }
  #undef PKW
  #undef PAF
  #undef VFR
  #undef PIN
  #undef MX3
  #undef GAPA
  #undef GAPB
  #undef EX
  #undef VRD
  #undef KRD
  #undef STEP
  #undef ENDW
  {auto rr=__builtin_amdgcn_permlane32_swap(__float_as_uint(l_reg),__float_as_uint(l_reg),false,false);l_reg=__uint_as_float(rr[0])+__uint_as_float(rr[1]);}
  if(hi==0)wsf[32+r32]=l_reg;asm volatile("s_waitcnt lgkmcnt(0)":::"memory");
  float rli[16];
  #pragma unroll
  for(int r=0;r<16;++r)rli[r]=__builtin_amdgcn_rcpf(wsf[32+crow(r,hi)]);
  bf16*Ow=O+(rowbase+q0+wid*QBLK)*OP+h*D;
  { bf16*stg=(bf16*)(shm+LDS_OST)+wid*2048;
    #pragma unroll
    for(int r=0;r<16;++r){const int orow=crow(r,hi);
      #pragma unroll
      for(int d0=0;d0<2;++d0)stg[orow*64+d0*32+r32]=__float2bfloat16(o[d0][r]*rli[r]);}
    asm volatile("s_waitcnt lgkmcnt(0)":::"memory");
    #pragma unroll
    for(int i=0;i<4;++i){const int row=i*8+(lane>>3),ch=lane&7; const u32x4 v=*(const u32x4*)(stg+row*64+ch*8); ATTN_STORE16(Ow+(long)row*OP+ch*8,v);} }
  asm volatile("s_waitcnt lgkmcnt(0)\n\ts_barrier":::"memory");
  #undef DMA_K
  #undef DMA_V
  #undef CMASK
  #undef START
  #undef RESC
  #undef ROT
}
constexpr int ATTN_LDS_BYTES=LDS_BYTES;
#undef SBAR
#undef WAIT_BAR
}
#define GAS __attribute__((address_space(1)))
#define LAS __attribute__((address_space(3)))
typedef unsigned short bf16;
typedef unsigned v4u __attribute__((ext_vector_type(4)));
typedef unsigned v2u __attribute__((ext_vector_type(2)));
typedef float f32x4 __attribute__((ext_vector_type(4)));
typedef short bf16x8 __attribute__((ext_vector_type(8)));

constexpr int DM = 1024, DEPTH = 4, DIN = 1792, DFF = 4096;
constexpr int TP = 32768, TS = 16384, TT = TP + TS;
constexpr int SEQ_P = 16384, SEQ_S = 8192;
constexpr int FCH = 16384, NFCH = TT / FCH;
constexpr float EPS = 1e-6f;
constexpr float QSCALE = 0.125f * 1.4426950408889634f;
constexpr size_t MiB = 1u << 20;
constexpr size_t WS_ROPE = 0;
constexpr size_t WS_SGW = 1 * MiB;
constexpr size_t WS_W = 2 * MiB, W_LAYER = 22544384;
constexpr size_t W_IN = 0, W_OUT = 3670016, W_1 = 5767168, W_2 = 14155776;
constexpr size_t WS_XN = 88 * MiB;
constexpr size_t WS_Q = 184 * MiB, WS_KV = 232 * MiB, WS_U = 256 * MiB, WS_VV = 304 * MiB;
constexpr size_t WS_AG = 352 * MiB;
constexpr size_t WS_H = WS_Q;
constexpr size_t WS_END = 448 * MiB;
static_assert(WS_W + 4 * W_LAYER <= WS_XN && WS_H + (size_t)FCH * DFF * 2 <= WS_AG, "ws map");
constexpr int LDS_BYTES = 147456;

__device__ __forceinline__ float wave_sum(float v) {
#pragma unroll
    for (int o = 1; o < 64; o <<= 1) v += __shfl_xor(v, o);
    return v;
}
typedef float f32x2_t __attribute__((ext_vector_type(2))); typedef __bf16 bf16x2_t __attribute__((ext_vector_type(2)));
__device__ __forceinline__ unsigned pkbf(float lo, float hi) { f32x2_t v = {lo, hi}; bf16x2_t b = __builtin_convertvector(v, bf16x2_t); return __builtin_bit_cast(unsigned, b); }
__device__ __forceinline__ float bflo(unsigned w) { return __uint_as_float(w << 16); }
__device__ __forceinline__ float bfhi(unsigned w) { return __uint_as_float(w & 0xffff0000u); }
__device__ __forceinline__ void unpack8(const v4u w, float* x) { x[0] = bflo(w.x); x[1] = bfhi(w.x); x[2] = bflo(w.y); x[3] = bfhi(w.y); x[4] = bflo(w.z); x[5] = bfhi(w.z); x[6] = bflo(w.w); x[7] = bfhi(w.w); }
__device__ __forceinline__ v4u pack8(const float* x) { v4u w; w.x = pkbf(x[0], x[1]); w.y = pkbf(x[2], x[3]); w.z = pkbf(x[4], x[5]); w.w = pkbf(x[6], x[7]); return w; }
__device__ __forceinline__ float gelu_tanh(float x) { const float y = 0.7978845608028654f * (x + 0.044715f * x * x * x); return x / (1.0f + __expf(-2.0f * y)); }
__device__ __forceinline__ float dot4(const f32x4 a) { return (a.x * a.x + a.y * a.y) + (a.z * a.z + a.w * a.w); }

__device__ __forceinline__ void p0_transpose_item(const float* W, int K, int N, bf16* WT, LAS float* scr, int item, int lane) {
    const int nblk = N / 32, kb = item / nblk, nb = item % nblk, k0 = 64 * kb, n0 = 32 * nb;
#pragma unroll 8
    for (int i = 0; i < 32; ++i) { const int kk = 2 * i + (lane >> 5); scr[kk * 33 + (lane & 31)] = W[(size_t)(k0 + kk) * N + n0 + (lane & 31)]; }
    asm volatile("s_waitcnt lgkmcnt(0)" ::: "memory");
    const int c = lane & 7;
#pragma unroll
    for (int j = 0; j < 4; ++j) { const int n = (lane >> 3) + 8 * j; const LAS float* s = scr + (8 * c) * 33 + n;
        v4u o; o.x = pkbf(s[0 * 33], s[1 * 33]); o.y = pkbf(s[2 * 33], s[3 * 33]); o.z = pkbf(s[4 * 33], s[5 * 33]); o.w = pkbf(s[6 * 33], s[7 * 33]);
        *(v4u*)(WT + (size_t)(n0 + n) * K + k0 + 8 * c) = o; }
    asm volatile("s_waitcnt lgkmcnt(0)" ::: "memory");
}
__device__ __forceinline__ void norm_row(const float* xrow, bf16* orow, const float* g, int lane) {
    f32x4 v[4]; float s = 0.f;
#pragma unroll
    for (int j = 0; j < 4; ++j) { v[j] = ((const f32x4*)xrow)[lane + 64 * j]; s += dot4(v[j]); }
    const float rs = rsqrtf(wave_sum(s) * (1.f / DM) + EPS);
#pragma unroll
    for (int j = 0; j < 4; ++j) { const f32x4 gv = ((const f32x4*)g)[lane + 64 * j]; const f32x4 o = v[j] * rs * gv; v2u w; w.x = pkbf(o.x, o.y); w.y = pkbf(o.z, o.w); ((v2u*)orow)[lane + 64 * j] = w; }
}
__device__ __forceinline__ void post_row(const bf16* mrow, const float* xin, float* xout, bf16* xnrow, const float* gpost, const float* gnext, int lane) {
    f32x4 m[4], x[4]; float s = 0.f;
#pragma unroll
    for (int j = 0; j < 4; ++j) { const v2u w = ((const v2u*)mrow)[lane + 64 * j]; m[j] = (f32x4){bflo(w.x), bfhi(w.x), bflo(w.y), bfhi(w.y)}; x[j] = ((const f32x4*)xin)[lane + 64 * j]; s += dot4(m[j]); }
    const float rs = rsqrtf(wave_sum(s) * (1.f / DM) + EPS);
    float s2 = 0.f;
#pragma unroll
    for (int j = 0; j < 4; ++j) { const f32x4 gp = ((const f32x4*)gpost)[lane + 64 * j]; x[j] = x[j] + m[j] * rs * gp; ((f32x4*)xout)[lane + 64 * j] = x[j]; s2 += dot4(x[j]); }
    if (xnrow) {
        const float rs2 = rsqrtf(wave_sum(s2) * (1.f / DM) + EPS);
#pragma unroll
        for (int j = 0; j < 4; ++j) { const f32x4 gn = ((const f32x4*)gnext)[lane + 64 * j]; const f32x4 o = x[j] * rs2 * gn; v2u w; w.x = pkbf(o.x, o.y); w.y = pkbf(o.z, o.w); ((v2u*)xnrow)[lane + 64 * j] = w; }
    }
}
__device__ __forceinline__ void qk_rope8(float* x, const float* gain, const float* cs, const float* sn, float sgn, float scale, int sub) {
    float ss = 0.f;
#pragma unroll
    for (int i = 0; i < 8; ++i) ss += x[i] * x[i];
    ss += __shfl_xor(ss, 1); ss += __shfl_xor(ss, 2); ss += __shfl_xor(ss, 4);
    const float rs = rsqrtf(ss * (1.f / 64.f) + EPS);
    const f32x4 g0 = *(const f32x4*)(gain + sub * 8), g1 = *(const f32x4*)(gain + sub * 8 + 4);
    const float g[8] = {g0.x, g0.y, g0.z, g0.w, g1.x, g1.y, g1.z, g1.w};
    float y[8];
#pragma unroll
    for (int i = 0; i < 8; ++i) y[i] = x[i] * rs * g[i];
#pragma unroll
    for (int i = 0; i < 8; ++i) { const float yp = __shfl_xor(y[i], 2); x[i] = (y[i] * cs[i] + sgn * yp * sn[i]) * scale; }
}
__device__ __forceinline__ void prep_row(int t, bf16* Q, bf16* KV, bf16* U, bf16* VV, const float* rope, const float* qg, const float* kg, const float* lng, const float* lnb, int lane) {
    const int s = t < TP ? (t & (SEQ_P - 1)) : ((t - TP) & (SEQ_S - 1));
    const int sub = lane & 7, axis = sub >> 2, half = (sub >> 1) & 1, f0 = (sub & 1) * 8;
    const int pos = axis ? (s & 63) : (s >> 6);
    float cs[8], sn[8];
    { const f32x4* rp = (const f32x4*)(rope + (size_t)(pos * 16 + f0) * 2);
#pragma unroll
      for (int i = 0; i < 4; ++i) { const f32x4 r = rp[i]; cs[2 * i] = r.x; sn[2 * i] = r.y; cs[2 * i + 1] = r.z; sn[2 * i + 1] = r.w; } }
    const float sgn = half ? 1.f : -1.f;
    { bf16* p = Q + (size_t)t * 512 + lane * 8; float x[8]; unpack8(*(const v4u*)p, x); qk_rope8(x, qg, cs, sn, sgn, QSCALE, sub); *(v4u*)p = pack8(x); }
    { bf16* p = KV + (size_t)t * 256 + (lane & 15) * 8; float x[8]; v4u w = (v4u){0u, 0u, 0u, 0u}; if (lane < 16) w = *(const v4u*)p; unpack8(w, x); qk_rope8(x, kg, cs, sn, sgn, 1.0f, sub); if (lane < 16) *(v4u*)p = pack8(x); }
    { bf16* p = U + (size_t)t * 512 + lane * 8; float x[8]; unpack8(*(const v4u*)p, x);
#pragma unroll
      for (int i = 0; i < 8; ++i) x[i] = gelu_tanh(x[i]);
      *(v4u*)p = pack8(x); }
    { bf16* p = VV + (size_t)t * 512 + lane * 8; float x[8]; unpack8(*(const v4u*)p, x); float sm = 0.f;
#pragma unroll
      for (int i = 0; i < 8; ++i) { x[i] = gelu_tanh(x[i]); sm += x[i]; }
      const float mu = wave_sum(sm) * (1.f / 512.f); float q = 0.f;
#pragma unroll
      for (int i = 0; i < 8; ++i) { x[i] -= mu; q += x[i] * x[i]; }
      const float rstd = rsqrtf(wave_sum(q) * (1.f / 512.f) + EPS);
      const f32x4 g0 = *(const f32x4*)(lng + lane * 8), g1 = *(const f32x4*)(lng + lane * 8 + 4), b0 = *(const f32x4*)(lnb + lane * 8), b1 = *(const f32x4*)(lnb + lane * 8 + 4);
      const float g[8] = {g0.x, g0.y, g0.z, g0.w, g1.x, g1.y, g1.z, g1.w}, b[8] = {b0.x, b0.y, b0.z, b0.w, b1.x, b1.y, b1.z, b1.w};
#pragma unroll
      for (int i = 0; i < 8; ++i) x[i] = x[i] * rstd * g[i] + b[i];
      *(v4u*)p = pack8(x); }
}
__device__ __forceinline__ void agnorm_row(bf16* row, const float* ga, const float* gg, int lane) {
#pragma unroll
    for (int hsel = 0; hsel < 2; ++hsel) {
        bf16* p = row + hsel * 512 + lane * 8; const float* gn = (hsel ? gg : ga) + lane * 8;
        float x[8]; unpack8(*(const v4u*)p, x); float ss = 0.f;
#pragma unroll
        for (int i = 0; i < 8; ++i) ss += x[i] * x[i];
        const float rs = rsqrtf(wave_sum(ss) * (1.f / 512.f) + EPS);
        const f32x4 g0 = *(const f32x4*)gn, g1 = *(const f32x4*)(gn + 4); const float g[8] = {g0.x, g0.y, g0.z, g0.w, g1.x, g1.y, g1.z, g1.w};
#pragma unroll
        for (int i = 0; i < 8; ++i) x[i] = x[i] * rs * g[i];
        *(v4u*)p = pack8(x);
    }
}
__device__ __forceinline__ void sg_unit(int chunk, int grp, int l, const bf16* VV, const bf16* U, bf16* AG, const bf16* SGW, const float* sgb, LAS unsigned char* lds, int tid, int wave, int lane) {
    const size_t R0 = (size_t)chunk * 128;
    LAS bf16* vt = (LAS bf16*)lds;
    { const int j = tid >> 2, cp = (tid & 3) * 16; const bf16* src = VV + (R0 + j) * 512 + grp * 64 + cp;
      const v4u a = *(const v4u*)src, b = *(const v4u*)(src + 8);
      const unsigned wv[8] = {a.x, a.y, a.z, a.w, b.x, b.y, b.z, b.w};
#pragma unroll
      for (int e = 0; e < 8; ++e) { vt[(cp + 2 * e) * 136 + j] = (bf16)(wv[e] & 0xffffu); vt[(cp + 2 * e + 1) * 136 + j] = (bf16)(wv[e] >> 16); } }
    __syncthreads();
    const int fr = lane & 15, fq = lane >> 4, i0 = wave * 16;
    f32x4 acc[4];
#pragma unroll
    for (int nb = 0; nb < 4; ++nb) acc[nb] = (f32x4){0.f, 0.f, 0.f, 0.f};
    const bf16* wrow = SGW + ((size_t)(l * 8 + grp) * 128 + i0 + fr) * 128 + fq * 8;
#pragma unroll
    for (int ks = 0; ks < 4; ++ks) { const bf16x8 af = *(const bf16x8*)(wrow + ks * 32);
#pragma unroll
        for (int nb = 0; nb < 4; ++nb) { const bf16x8 bfr = *(const LAS bf16x8*)(vt + (nb * 16 + fr) * 136 + ks * 32 + fq * 8);
            acc[nb] = __builtin_amdgcn_mfma_f32_16x16x32_bf16(bfr, af, acc[nb], 0, 0, 0); } }
    const float bias = sgb[(l * 8 + grp) * 128 + i0 + fr];
    const size_t row = R0 + i0 + fr;
#pragma unroll
    for (int nb = 0; nb < 4; ++nb) { const int c = grp * 64 + nb * 16 + 4 * fq; const v2u uw = *(const v2u*)(U + row * 512 + c);
        const float o0 = bflo(uw.x) * (acc[nb].x + bias), o1 = bfhi(uw.x) * (acc[nb].y + bias), o2 = bflo(uw.y) * (acc[nb].z + bias), o3 = bfhi(uw.y) * (acc[nb].w + bias);
        v2u w; w.x = pkbf(o0, o1); w.y = pkbf(o2, o3); *(v2u*)(AG + row * 1024 + 512 + c) = w; }
    __syncthreads();
}

struct Args { const float* in[18]; float* out; unsigned char* ws; };
#ifndef SKIP_ATTN
#define SKIP_ATTN 0
#endif
#ifndef SKIP_GEMM
#define SKIP_GEMM 0
#endif
#ifndef SKIP_ELT
#define SKIP_ELT 0
#endif
__global__ void __launch_bounds__(512, 2) fwd(Args args) {
    extern __shared__ __attribute__((aligned(16))) unsigned char lds[];
    cg::grid_group grid = cg::this_grid();
    LAS unsigned char* L = (LAS unsigned char*)lds;
    int tid = threadIdx.x, lane = tid & 63, wave = __builtin_amdgcn_readfirstlane(tid >> 6);
#define FRESH() do { int t_ = threadIdx.x; asm volatile("" : "+v"(t_)); tid = t_; lane = t_ & 63; wave = __builtin_amdgcn_readfirstlane(t_ >> 6); gw = vcu * 8 + wave; } while (0)
    const int G = gridDim.x, bx = blockIdx.x;
    const int vcu = (G % 8 == 0) ? (bx % 8) * (G / 8) + bx / 8 : bx;
    int gw = vcu * 8 + wave; const int NGW = G * 8;
    unsigned char* ws = args.ws;
    const float *x_prompt = args.in[0], *x_sample = args.in[1], *w_in = args.in[2], *w_out = args.in[3], *q_norm_g = args.in[4], *k_norm_g = args.in[5],
                *sg_norm_g = args.in[6], *sg_norm_b = args.in[7], *sg_w = args.in[8], *sg_b = args.in[9], *attn_out_g = args.in[10], *sg_out_g = args.in[11],
                *pre_mix_g = args.in[12], *post_mix_g = args.in[13], *pre_ffn_g = args.in[14], *post_ffn_g = args.in[15], *w_ff1 = args.in[16], *w_ff2 = args.in[17];
    float* out = args.out;
    float* rope = (float*)(ws + WS_ROPE); bf16* SGW = (bf16*)(ws + WS_SGW);
    bf16 *XN = (bf16*)(ws + WS_XN), *Q = (bf16*)(ws + WS_Q), *KV = (bf16*)(ws + WS_KV), *U = (bf16*)(ws + WS_U), *VV = (bf16*)(ws + WS_VV), *AG = (bf16*)(ws + WS_AG), *H = (bf16*)(ws + WS_H);

    {
        LAS float* scr = (LAS float*)(L + wave * 16384);
        constexpr int I_IN = (DM / 64) * (DIN / 32), I_OUT = (DM / 64) * (DM / 32), I_1 = (DM / 64) * (DFF / 32), I_2 = (DFF / 64) * (DM / 32), I_L = I_IN + I_OUT + I_1 + I_2;
        for (int it = gw; it < DEPTH * I_L; it += NGW) {
            const int l = it / I_L; int r = it % I_L; unsigned char* wl = ws + WS_W + (size_t)l * W_LAYER;
            if (r < I_IN) { p0_transpose_item(w_in + (size_t)l * DM * DIN, DM, DIN, (bf16*)(wl + W_IN), scr, r, lane); continue; } r -= I_IN;
            if (r < I_OUT) { p0_transpose_item(w_out + (size_t)l * DM * DM, DM, DM, (bf16*)(wl + W_OUT), scr, r, lane); continue; } r -= I_OUT;
            if (r < I_1) { p0_transpose_item(w_ff1 + (size_t)l * DM * DFF, DM, DFF, (bf16*)(wl + W_1), scr, r, lane); continue; } r -= I_1;
            p0_transpose_item(w_ff2 + (size_t)l * DFF * DM, DFF, DM, (bf16*)(wl + W_2), scr, r, lane);
        }
        const int gt = gw * 64 + lane, NGT = NGW * 64;
        for (int i = gt; i < DEPTH * 8 * 128 * 128 / 8; i += NGT) { const f32x4 a = ((const f32x4*)sg_w)[2 * i], b = ((const f32x4*)sg_w)[2 * i + 1];
            v4u o; o.x = pkbf(a.x, a.y); o.y = pkbf(a.z, a.w); o.z = pkbf(b.x, b.y); o.w = pkbf(b.z, b.w); ((v4u*)SGW)[i] = o; }
        for (int i = gt; i < 256 * 16; i += NGT) { const int pos = i >> 4, f = i & 15;
            const float inv = exp2f(-(float)f * (13.287712379549449f / 16.0f));
            const float ang = (float)pos * inv;
            double rev = (double)ang * 0.15915494309189535; rev -= __builtin_rint(rev);
            const float fr = (float)rev;
            rope[2 * i] = __builtin_amdgcn_cosf(fr); rope[2 * i + 1] = __builtin_amdgcn_sinf(fr); }
        for (int t = gw; t < TT; t += NGW) { const float* xr = t < TP ? x_prompt + (size_t)t * DM : x_sample + (size_t)(t - TP) * DM; norm_row(xr, XN + (size_t)t * DM, pre_mix_g, lane); }
    }
    grid.sync();

    for (int l = 0; l < DEPTH; ++l) {
        unsigned char* wl = ws + WS_W + (size_t)l * W_LAYER;
        if (!SKIP_GEMM) { pg8::Gemm g{XN, (const bf16*)(wl + W_IN), TT, DIN, DM}; pg8::StaticOrder S; S.init(TT, DIN, G, bx);
          pg8::EpiOut<2> E{Q, 512, KV, U, VV};
          pg8::gemm_phase<pg8::EpiOut<2>, pg8::StaticOrder, true, true>(L, g, S, E); }
        grid.sync();
        FRESH();
        if (!SKIP_ELT) for (int t = gw; t < TT; t += NGW) prep_row(t, Q, KV, U, VV, rope, q_norm_g + l * 64, k_norm_g + l * 64, sg_norm_g + l * 512, sg_norm_b + l * 512, lane);
        grid.sync();
        FRESH();
        if (!SKIP_ELT) for (int n = vcu; n < (TT / 128) * 8; n += G) sg_unit(n >> 3, n & 7, l, VV, U, AG, SGW, sg_b, L, tid, wave, lane);
        if (!SKIP_ATTN) {
            for (int i = 0;; ++i) {
                int n;
                if (G == 256) { if (i >= 6) break; n = i < 4 ? vcu * 4 + i : 1024 + vcu * 2 + (i - 4); }
                else { n = i * G + vcu; if (n >= 1536) break; }
                long rowbase; int hh, kvh, qb, NT;
                if (n < 1024) { const int combo = n >> 8, u = n & 255; rowbase = (long)(combo >> 1) * SEQ_P; kvh = combo & 1; hh = kvh * 4 + (u >> 6); qb = u & 63; NT = SEQ_P / 64; }
                else { const int n2 = n - 1024, combo = n2 >> 7, u = n2 & 127; rowbase = (long)TP + (long)(combo >> 1) * SEQ_S; kvh = combo & 1; hh = kvh * 4 + (u >> 5); qb = u & 31; NT = SEQ_S / 64; }
                attn_body::attn_unit<8>(rowbase, hh, kvh, qb, NT, (const attn_body::bf16*)Q, (const attn_body::bf16*)KV, (attn_body::bf16*)AG, (char*)lds);
            }
        }
        grid.sync();
        FRESH();
        if (!SKIP_ELT) for (int t = gw; t < TT; t += NGW) agnorm_row(AG + (size_t)t * 1024, attn_out_g + l * 512, sg_out_g + l * 512, lane);
        grid.sync();
        if (!SKIP_GEMM) { pg8::Gemm g{AG, (const bf16*)(wl + W_OUT), TT, DM, DM}; pg8::StaticOrder S; S.init(TT, DM, G, bx);
          pg8::EpiOut<0> E{XN, DM, nullptr, nullptr, nullptr};
          pg8::gemm_phase<pg8::EpiOut<0>, pg8::StaticOrder, true, true>(L, g, S, E); }
        grid.sync();
        FRESH();
        if (!SKIP_ELT) for (int t = gw; t < TT; t += NGW) { const float* xr = (l == 0) ? (t < TP ? x_prompt + (size_t)t * DM : x_sample + (size_t)(t - TP) * DM) : out + (size_t)t * DM;
            post_row(XN + (size_t)t * DM, xr, out + (size_t)t * DM, XN + (size_t)t * DM, post_mix_g + l * DM, pre_ffn_g + l * DM, lane); }
        grid.sync();
        for (int c = 0; c < NFCH; ++c) {
            if (!SKIP_GEMM) { pg8::Gemm g{XN + (size_t)c * FCH * DM, (const bf16*)(wl + W_1), FCH, DFF, DM}; pg8::StaticOrder S; S.init(FCH, DFF, G, bx);
              pg8::EpiOut<1> E{H, DFF, nullptr, nullptr, nullptr};
              pg8::gemm_phase<pg8::EpiOut<1>, pg8::StaticOrder, true, true>(L, g, S, E); }
            grid.sync();
            if (!SKIP_GEMM) { pg8::Gemm g{H, (const bf16*)(wl + W_2), FCH, DM, DFF}; pg8::StaticOrder S; S.init(FCH, DM, G, bx);
              pg8::EpiOut<0> E{AG + (size_t)c * FCH * DM, DM, nullptr, nullptr, nullptr};
              pg8::gemm_phase<pg8::EpiOut<0>, pg8::StaticOrder, true, true>(L, g, S, E); }
            grid.sync();
        }
        FRESH();
        if (!SKIP_ELT) for (int t = gw; t < TT; t += NGW)
            post_row(AG + (size_t)t * DM, out + (size_t)t * DM, out + (size_t)t * DM, (l + 1 < DEPTH) ? XN + (size_t)t * DM : nullptr, post_ffn_g + l * DM, pre_mix_g + (l + 1 < DEPTH ? l + 1 : l) * DM, lane);
        if (l + 1 < DEPTH) grid.sync();
    }
}

extern "C" void kernel_launch(void* const* d_in, const int* in_sizes, int n_in, void* d_out, int out_size, void* d_ws, size_t ws_size, hipStream_t stream) {
    static int grid = 0;
    if (grid == 0) {
        if (n_in != 18 || out_size != TT * DM || ws_size < WS_END) { fprintf(stderr, "kernel_launch: unexpected shapes (n_in %d out %d ws %zu)\n", n_in, out_size, ws_size); grid = -1; return; }
        int dev = 0, cus = 0, per_cu = 0;
        if (hipGetDevice(&dev) != hipSuccess || hipDeviceGetAttribute(&cus, hipDeviceAttributeMultiprocessorCount, dev) != hipSuccess) { grid = -1; return; }
        if (hipFuncSetAttribute((const void*)fwd, hipFuncAttributeMaxDynamicSharedMemorySize, LDS_BYTES) != hipSuccess) { fprintf(stderr, "kernel_launch: hipFuncSetAttribute failed\n"); grid = -1; return; }
        if (hipOccupancyMaxActiveBlocksPerMultiprocessor(&per_cu, (const void*)fwd, 512, LDS_BYTES) != hipSuccess || per_cu < 1) { fprintf(stderr, "kernel_launch: occupancy query says %d\n", per_cu); per_cu = 1; }
        (void)hipGetLastError();
        grid = cus * 1;
    }
    if (grid < 0) return;
    Args a{};
    for (int i = 0; i < 18; ++i) a.in[i] = (const float*)d_in[i];
    a.out = (float*)d_out; a.ws = (unsigned char*)d_ws;
    void* params[] = {&a};
    hipError_t e = hipLaunchCooperativeKernel((const void*)fwd, dim3(grid), dim3(512), params, LDS_BYTES, stream);
    if (e != hipSuccess) fprintf(stderr, "cooperative launch failed: %s (grid %d)\n", hipGetErrorString(e), grid);
}
```
